# Optimizing an MI355X kernel written in HIP

```python
import math
import jax, jax.numpy as jnp
from jax import lax
import numpy as np

D_MODEL = 1024
BATCH = 1
SEQ = 16384
DEPTH = 1
DEC_BATCH = 16
DEC_SEQ = 64
PAST_LEN = 2048

CHUNK = 64
N_MEM = 256
EPS = 1e-6
SWA_HEADS = 16
SWA_KV_HEADS = 2
SWA_HEAD_DIM = 64
SWA_GROUP = SWA_HEADS // SWA_KV_HEADS
WINDOW = 128
ROPE_THETA = 10000.0
GDN_HEADS = 8
GDN_DK = 128
GDN_DV = 128
CONV_W = 4
MEM_HEADS = 4
MEM_HEAD_DIM = 256
N_BRANCH = 3
D_FF = 4 * D_MODEL

SWA_Q = SWA_HEADS * SWA_HEAD_DIM
SWA_KV = SWA_KV_HEADS * SWA_HEAD_DIM
GDN_QK = GDN_HEADS * GDN_DK
GDN_V = GDN_HEADS * GDN_DV
CONV_CH = 2 * GDN_QK + GDN_V
MEM_Q = MEM_HEADS * MEM_HEAD_DIM
SPLIT_SIZES = (SWA_Q, SWA_KV, SWA_KV, GDN_QK, GDN_QK, GDN_V, GDN_V, GDN_HEADS, GDN_HEADS, MEM_Q, N_BRANCH * D_MODEL)
D_IN = sum(SPLIT_SIZES)

kernel_name = 'streaming_hybrid_swa_gdn_mem'


def split_cols(x, sizes):
    out = []
    start = 0
    for s in sizes:
        out.append(x[..., start:start + s])
        start += s
    return out


def rmsnorm(x, g):
    xf = x.astype(jnp.float32)
    y = xf * lax.rsqrt(jnp.mean(xf * xf, axis=-1, keepdims=True) + EPS)
    return (y * g.astype(jnp.float32)).astype(x.dtype)


def l2norm(x):
    return x * lax.rsqrt(jnp.sum(x * x, axis=-1, keepdims=True) + EPS)


def rope(x, pos):
    half = x.shape[-1] // 2
    inv = ROPE_THETA ** (-jnp.arange(half, dtype=jnp.float32) / half)
    ang = pos.astype(jnp.float32)[:, None] * inv[None, :]
    cos = jnp.cos(ang)[:, None, :]
    sin = jnp.sin(ang)[:, None, :]
    xf = x.astype(jnp.float32)
    x1, x2 = xf[..., :half], xf[..., half:]
    return jnp.concatenate([x1 * cos - x2 * sin, x2 * cos + x1 * sin], axis=-1).astype(x.dtype)


def sink_attention(qg, kb, vb, sinks, valid):
    B, C, Q = qg.shape[:3]
    s = jnp.einsum('bcqkgd,bcskd->bckgqs', qg, kb).astype(jnp.float32) * (SWA_HEAD_DIM ** -0.5)
    s = jnp.where(valid[None, :, None, None, None, :], s, -jnp.inf)
    sink = sinks.astype(jnp.float32).reshape(1, 1, SWA_KV_HEADS, SWA_GROUP, 1, 1)
    m = jnp.maximum(jnp.max(s, axis=-1, keepdims=True), sink)
    e = jnp.exp(s - m)
    p = e / (jnp.sum(e, axis=-1, keepdims=True) + jnp.exp(sink - m))
    o = jnp.einsum('bckgqs,bcskd->bcqkgd', p.astype(vb.dtype), vb)
    return o.reshape(B, C * Q, SWA_Q)


def swa_attention(q, k, v, k_hist, v_hist, hist_valid, sinks):
    B, T = q.shape[:2]
    qb = min(T, CHUNK)
    nc = T // qb
    k_all = jnp.concatenate([k_hist, k], axis=1)
    v_all = jnp.concatenate([v_hist, v], axis=1)
    band = jnp.arange(nc)[:, None] * qb + jnp.arange(WINDOW + qb)[None, :]
    valid_all = jnp.concatenate([jnp.full((WINDOW,), hist_valid, dtype=bool), jnp.ones((T,), dtype=bool)])
    valid = valid_all[band]
    kb = jnp.take(k_all, band, axis=1)
    vb = jnp.take(v_all, band, axis=1)
    qg = q.reshape(B, nc, qb, SWA_KV_HEADS, SWA_GROUP, SWA_HEAD_DIM)
    o = sink_attention(qg, kb, vb, sinks, valid)
    return o, k_all[:, -WINDOW:], v_all[:, -WINDOW:]


def short_conv(x, buf, w):
    T = x.shape[1]
    xp = jnp.concatenate([buf, x], axis=1)
    y = xp[:, 0:T] * w[0]
    for i in range(1, CONV_W):
        y = y + xp[:, i:i + T] * w[i]
    return jax.nn.silu(y), xp[:, -(CONV_W - 1):]


def gdn_chunked(q, k, v, log_a, beta, S0, chunk):
    B, T, H, DK = q.shape
    DV = v.shape[-1]
    nc = T // chunk

    def blocks(t):
        t = t.reshape((B, nc, chunk) + t.shape[2:])
        return jnp.moveaxis(t, 2, 3)

    qc, kc, vc, bc = blocks(q), blocks(k), blocks(v), blocks(beta)
    g = jnp.cumsum(blocks(log_a), axis=-1)
    i = jnp.arange(chunk)
    incl = i[:, None] >= i[None, :]
    strict = i[:, None] > i[None, :]
    decay = jnp.exp(jnp.where(incl, g[..., :, None] - g[..., None, :], -jnp.inf))
    kk = jnp.einsum('bnhid,bnhjd->bnhij', kc, kc)
    A = jnp.where(strict, bc[..., :, None] * kk * decay, 0.0) + jnp.eye(chunk, dtype=q.dtype)
    rhs = jnp.concatenate([vc * bc[..., None], kc * (bc * jnp.exp(g))[..., None]], axis=-1)
    sol = lax.linalg.triangular_solve(A, rhs, left_side=True, lower=True, unit_diagonal=True)
    u, w = sol[..., :DV], sol[..., DV:]
    qk = jnp.einsum('bnhid,bnhjd->bnhij', qc, kc) * decay
    q_dec = qc * jnp.exp(g)[..., None]
    k_dec = kc * jnp.exp(g[..., -1:] - g)[..., None]
    g_tot = jnp.exp(g[..., -1])

    def step(S, xs):
        u_n, w_n, qk_n, qd_n, kd_n, gt_n = xs
        v_new = u_n - jnp.einsum('bhid,bhde->bhie', w_n, S)
        o = jnp.einsum('bhid,bhde->bhie', qd_n, S) + jnp.einsum('bhij,bhje->bhie', qk_n, v_new)
        S = S * gt_n[..., None, None] + jnp.einsum('bhid,bhie->bhde', kd_n, v_new)
        return S, o

    xs = (jnp.moveaxis(u, 1, 0), jnp.moveaxis(w, 1, 0), jnp.moveaxis(qk, 1, 0),
          jnp.moveaxis(q_dec, 1, 0), jnp.moveaxis(k_dec, 1, 0), jnp.moveaxis(g_tot, 1, 0))
    S, o = lax.scan(step, S0, xs)
    o = jnp.moveaxis(jnp.moveaxis(o, 0, 1), 3, 2).reshape(B, T, H, DV)
    return o, S


def gated_delta_branch(q, k, v, z, a, b, conv_buf, S0, conv_w, a_log, dt_bias, norm_g):
    B, T, _ = q.shape
    qkv, conv_new = short_conv(jnp.concatenate([q, k, v], axis=-1), conv_buf, conv_w)
    qh, kh, vh = split_cols(qkv, (GDN_QK, GDN_QK, GDN_V))
    qh = l2norm(qh.reshape(B, T, GDN_HEADS, GDN_DK).astype(jnp.float32)) * (GDN_DK ** -0.5)
    kh = l2norm(kh.reshape(B, T, GDN_HEADS, GDN_DK).astype(jnp.float32))
    vh = vh.reshape(B, T, GDN_HEADS, GDN_DV).astype(jnp.float32)
    beta = jax.nn.sigmoid(b.astype(jnp.float32))
    log_a = -jnp.exp(a_log.astype(jnp.float32)) * jax.nn.softplus(a.astype(jnp.float32) + dt_bias.astype(jnp.float32))
    o, S = gdn_chunked(qh, kh, vh, log_a, beta, S0.astype(jnp.float32), min(T, CHUNK))
    o = rmsnorm(o, norm_g) * jax.nn.silu(z.reshape(B, T, GDN_HEADS, GDN_DV).astype(jnp.float32))
    return o.reshape(B, T, GDN_V).astype(q.dtype), S.astype(S0.dtype), conv_new


def memory_kv(mem, g_mem, w_mem_kv):
    B = mem.shape[0]
    k, v = split_cols(rmsnorm(mem, g_mem) @ w_mem_kv, (MEM_Q, MEM_Q))
    return (k.reshape(B, N_MEM, MEM_HEADS, MEM_HEAD_DIM), v.reshape(B, N_MEM, MEM_HEADS, MEM_HEAD_DIM))


def memory_attention(q, mem_k, mem_v):
    B, T = q.shape[:2]
    s = jnp.einsum('bqhd,bmhd->bhqm', q, mem_k).astype(jnp.float32) * (MEM_HEAD_DIM ** -0.5)
    p = jax.nn.softmax(s, axis=-1)
    o = jnp.einsum('bhqm,bmhd->bqhd', p.astype(mem_v.dtype), mem_v)
    return o.reshape(B, T, MEM_Q)


def hybrid_layer(x, pos, k_hist, v_hist, hist_valid, S0, conv_buf, mem_k, mem_v,
                 g_pre_mix, w_in, b_in, swa_sinks, conv_w, gdn_a_log, gdn_dt_bias, gdn_norm_g,
                 w_branch, w_out, g_post_mix, g_pre_ffn, w_up, w_down, g_post_ffn):
    B, T, _ = x.shape
    h = rmsnorm(x, g_pre_mix)
    proj = h @ w_in + b_in
    qa, ka, va, qb, kb, vb, zb, ab, bb, qc, gl = split_cols(proj, SPLIT_SIZES)
    qa = rope(qa.reshape(B, T, SWA_HEADS, SWA_HEAD_DIM), pos)
    ka = rope(ka.reshape(B, T, SWA_KV_HEADS, SWA_HEAD_DIM), pos)
    va = va.reshape(B, T, SWA_KV_HEADS, SWA_HEAD_DIM)
    o_a, k_new, v_new = swa_attention(qa, ka, va, k_hist, v_hist, hist_valid, swa_sinks)
    o_b, S_new, conv_new = gated_delta_branch(qb, kb, vb, zb, ab, bb, conv_buf, S0, conv_w,
                                              gdn_a_log, gdn_dt_bias, gdn_norm_g)
    o_c = memory_attention(qc.reshape(B, T, MEM_HEADS, MEM_HEAD_DIM), mem_k, mem_v)
    branches = jnp.stack([o_a, o_b, o_c], axis=2)
    br = jnp.einsum('btnc,ncd->btnd', branches, w_branch)
    gates = jax.nn.sigmoid(gl.reshape(B, T, N_BRANCH, D_MODEL).astype(jnp.float32)).astype(x.dtype)
    merged = jnp.sum(gates * br, axis=2)
    x = x + rmsnorm(merged @ w_out, g_post_mix)
    hf = rmsnorm(x, g_pre_ffn)
    f = jnp.square(jax.nn.relu(hf @ w_up)) @ w_down
    x = x + rmsnorm(f, g_post_ffn)
    return x, k_new, v_new, S_new, conv_new


def setup_inputs(seed: int = 0) -> dict:
    key = jax.random.key(seed)
    ks = jax.random.split(key, 32)
    f32 = jnp.float32

    def nrm(k, shape, scale):
        return jax.random.normal(k, shape, f32) * scale

    def gain(k, shape):
        return 1.0 + 0.05 * jax.random.normal(k, shape, f32)

    dt = jnp.exp(jax.random.uniform(ks[9], (DEPTH, GDN_HEADS), f32, math.log(1e-3), math.log(1e-1)))
    return {
        'x_prompt': nrm(ks[0], (BATCH, SEQ, D_MODEL), 1.0),
        'x_sample': nrm(ks[1], (DEC_BATCH, DEC_SEQ, D_MODEL), 1.0),
        'mem_prompt': nrm(ks[2], (BATCH, N_MEM, D_MODEL), 1.0),
        'cache_swa_k': nrm(ks[3], (DEPTH, DEC_BATCH, WINDOW, SWA_KV_HEADS, SWA_HEAD_DIM), 1.0),
        'cache_swa_v': nrm(ks[4], (DEPTH, DEC_BATCH, WINDOW, SWA_KV_HEADS, SWA_HEAD_DIM), 1.0),
        'state_gdn': nrm(ks[5], (DEPTH, DEC_BATCH, GDN_HEADS, GDN_DK, GDN_DV), 0.1),
        'state_conv': nrm(ks[6], (DEPTH, DEC_BATCH, CONV_W - 1, CONV_CH), 1.0),
        'cache_mem_k': nrm(ks[7], (DEPTH, DEC_BATCH, N_MEM, MEM_HEADS, MEM_HEAD_DIM), 1.0),
        'cache_mem_v': nrm(ks[8], (DEPTH, DEC_BATCH, N_MEM, MEM_HEADS, MEM_HEAD_DIM), 1.0),
        'g_pre_mix': gain(ks[10], (DEPTH, D_MODEL)),
        'w_in': nrm(ks[11], (DEPTH, D_MODEL, D_IN), D_MODEL ** -0.5),
        'b_in': nrm(ks[12], (DEPTH, D_IN), 0.02),
        'swa_sinks': nrm(ks[13], (DEPTH, SWA_HEADS), 1.0),
        'conv_w': nrm(ks[14], (DEPTH, CONV_W, CONV_CH), CONV_W ** -0.5),
        'gdn_a_log': jnp.log(jax.random.uniform(ks[15], (DEPTH, GDN_HEADS), f32, 1.0, 16.0)),
        'gdn_dt_bias': dt + jnp.log(-jnp.expm1(-dt)),
        'gdn_norm_g': gain(ks[16], (DEPTH, GDN_DV)),
        'g_mem': gain(ks[17], (DEPTH, D_MODEL)),
        'w_mem_kv': nrm(ks[18], (DEPTH, D_MODEL, 2 * MEM_Q), D_MODEL ** -0.5),
        'w_branch': nrm(ks[19], (DEPTH, N_BRANCH, D_MODEL, D_MODEL), D_MODEL ** -0.5),
        'w_out': nrm(ks[20], (DEPTH, D_MODEL, D_MODEL), D_MODEL ** -0.5),
        'g_post_mix': gain(ks[21], (DEPTH, D_MODEL)),
        'g_pre_ffn': gain(ks[22], (DEPTH, D_MODEL)),
        'w_up': nrm(ks[23], (DEPTH, D_MODEL, D_FF), D_MODEL ** -0.5),
        'w_down': nrm(ks[24], (DEPTH, D_FF, D_MODEL), D_FF ** -0.5),
        'g_post_ffn': gain(ks[25], (DEPTH, D_MODEL)),
    }


def reference(x_prompt, x_sample, mem_prompt, cache_swa_k, cache_swa_v, state_gdn, state_conv,
              cache_mem_k, cache_mem_v, g_pre_mix, w_in, b_in, swa_sinks, conv_w, gdn_a_log,
              gdn_dt_bias, gdn_norm_g, g_mem, w_mem_kv, w_branch, w_out, g_post_mix, g_pre_ffn,
              w_up, w_down, g_post_ffn):
    xp, xs = x_prompt, x_sample
    Bp, Tp = xp.shape[0], xp.shape[1]
    Ts = xs.shape[1]
    pos_p = jnp.arange(Tp, dtype=jnp.int32)
    pos_s = PAST_LEN + jnp.arange(Ts, dtype=jnp.int32)
    zero_kv = jnp.zeros((Bp, WINDOW, SWA_KV_HEADS, SWA_HEAD_DIM), xp.dtype)
    zero_S = jnp.zeros((Bp, GDN_HEADS, GDN_DK, GDN_DV), xp.dtype)
    zero_conv = jnp.zeros((Bp, CONV_W - 1, CONV_CH), xp.dtype)
    p_k, p_v, p_S, p_c, p_mk, p_mv = [], [], [], [], [], []
    s_k, s_v, s_S, s_c = [], [], [], []
    for l in range(DEPTH):
        mk, mv = memory_kv(mem_prompt, g_mem[l], w_mem_kv[l])
        xp, kp_, vp_, Sp_, cp_ = hybrid_layer(
            xp, pos_p, zero_kv, zero_kv, False, zero_S, zero_conv, mk, mv,
            g_pre_mix[l], w_in[l], b_in[l], swa_sinks[l], conv_w[l], gdn_a_log[l], gdn_dt_bias[l],
            gdn_norm_g[l], w_branch[l], w_out[l], g_post_mix[l], g_pre_ffn[l], w_up[l], w_down[l], g_post_ffn[l])
        xs, ks_, vs_, Ss_, cs_ = hybrid_layer(
            xs, pos_s, cache_swa_k[l], cache_swa_v[l], True, state_gdn[l], state_conv[l],
            cache_mem_k[l], cache_mem_v[l],
            g_pre_mix[l], w_in[l], b_in[l], swa_sinks[l], conv_w[l], gdn_a_log[l], gdn_dt_bias[l],
            gdn_norm_g[l], w_branch[l], w_out[l], g_post_mix[l], g_pre_ffn[l], w_up[l], w_down[l], g_post_ffn[l])
        p_k.append(kp_); p_v.append(vp_); p_S.append(Sp_); p_c.append(cp_); p_mk.append(mk); p_mv.append(mv)
        s_k.append(ks_); s_v.append(vs_); s_S.append(Ss_); s_c.append(cs_)
    return (xp, xs,
            jnp.stack(p_k), jnp.stack(p_v), jnp.stack(p_S), jnp.stack(p_c), jnp.stack(p_mk), jnp.stack(p_mv),
            jnp.stack(s_k), jnp.stack(s_v), jnp.stack(s_S), jnp.stack(s_c))
```

```cpp
#include <hip/hip_runtime.h>
#include <cstdint>
#include <cmath>

typedef unsigned short bf16_t;
constexpr int NP = 16384, NSAMP = 1024, NT = NP + NSAMP, DM = 1024, DIN = 9488, DFF = 4096;
constexpr int NCH = NT / 64;
constexpr int C_QA = 0, C_KA = 1024, C_VA = 1152, C_QB = 1280, C_KB = 2304, C_VB = 3328, C_ZB = 4352, C_AB = 5376, C_BB = 5384, C_QC = 5392, C_GL = 6416;
constexpr size_t O_Y = 0, O_PK = (size_t)NT * DM, O_PV = O_PK + 16384, O_PG = O_PV + 16384, O_PC = O_PG + 131072, O_PMK = O_PC + 9216,
                 O_PMV = O_PMK + 262144, O_SK = O_PMV + 262144, O_SV = O_SK + 262144, O_SG = O_SV + 262144, O_SC = O_SG + 2097152, O_END = O_SC + 147456;
constexpr size_t MiB = 1u << 20;
constexpr size_t WS_QA = 0, WS_QC = 34 * MiB, WS_CQ = 68 * MiB, WS_CK = 102 * MiB, WS_CV = 136 * MiB, WS_KA = 170 * MiB, WS_VA = 175 * MiB,
                 WS_HALO = 180 * MiB, WS_ABBB = 185 * MiB, WS_LA = 187 * MiB, WS_BETA = 188 * MiB, WS_MK = 189 * MiB, WS_MV = 190 * MiB, WS_MEMN = 191 * MiB;

__device__ __forceinline__ float bf2f(bf16_t b) { return __uint_as_float(((unsigned)b) << 16); }
__device__ __forceinline__ bf16_t f2bf(float f) { unsigned u = __float_as_uint(f); return (bf16_t)((u + 0x7fffu + ((u >> 16) & 1u)) >> 16); }
__device__ __forceinline__ float ldf(const float* p) { return *p; }
__device__ __forceinline__ float ldf(const bf16_t* p) { return bf2f(*p); }
__device__ __forceinline__ float sigmoidf_(float x) { return 1.f / (1.f + expf(-x)); }
__device__ __forceinline__ float wave_sum(float v) {
#pragma unroll
    for (int o = 1; o < 64; o <<= 1) v += __shfl_xor(v, o);
    return v;
}
__device__ __forceinline__ float wave_max(float v) {
#pragma unroll
    for (int o = 1; o < 64; o <<= 1) v = fmaxf(v, __shfl_xor(v, o));
    return v;
}

struct RopeTab { double inv_rev[32]; };

struct Ctx {
    const float* in[26];
    float* out;
    unsigned char* ws;
    RopeTab rt;
};
__device__ __forceinline__ const float* xrow(const Ctx& c, int tok) { return tok < NP ? c.in[0] + (size_t)tok * DM : c.in[1] + (size_t)(tok - NP) * DM; }

__global__ void __launch_bounds__(256) k_rms_h(Ctx c) {
    const int lane = threadIdx.x & 63, row = blockIdx.x * 4 + (threadIdx.x >> 6);
    if (row >= NT) return;
    const float* x = xrow(c, row); const float* g = c.in[9];
    float v[16]; float s = 0.f;
#pragma unroll
    for (int j = 0; j < 16; ++j) { v[j] = x[lane + 64 * j]; s += v[j] * v[j]; }
    const float rstd = 1.f / sqrtf(wave_sum(s) * (1.f / DM) + 1e-6f);
    bf16_t* H = (bf16_t*)c.out + (size_t)row * DM;
#pragma unroll
    for (int j = 0; j < 16; ++j) H[lane + 64 * j] = f2bf(v[j] * rstd * g[lane + 64 * j]);
}
__global__ void __launch_bounds__(256) k_rms_mem(Ctx c) {
    const int lane = threadIdx.x & 63, row = blockIdx.x * 4 + (threadIdx.x >> 6);
    if (row >= 256) return;
    const float* x = c.in[2] + (size_t)row * DM; const float* g = c.in[17];
    float v[16]; float s = 0.f;
#pragma unroll
    for (int j = 0; j < 16; ++j) { v[j] = x[lane + 64 * j]; s += v[j] * v[j]; }
    const float rstd = 1.f / sqrtf(wave_sum(s) * (1.f / DM) + 1e-6f);
    float* o = (float*)(c.ws + WS_MEMN) + (size_t)row * DM;
#pragma unroll
    for (int j = 0; j < 16; ++j) o[lane + 64 * j] = v[j] * rstd * g[lane + 64 * j];
}

template <class AT, class Epi>
__global__ void __launch_bounds__(256) k_gemm(const AT* A, int lda, const float* B, int ldb, int M, int N, int K, Epi epi) {
    __shared__ float As[16][68];
    __shared__ float Bs[16][68];
    const int t = threadIdx.x, tx = t & 15, ty = t >> 4;
    const int bm = blockIdx.y * 64, bn = blockIdx.x * 64;
    float acc[4][4];
#pragma unroll
    for (int i = 0; i < 4; ++i)
#pragma unroll
        for (int j = 0; j < 4; ++j) acc[i][j] = 0.f;
    const int ar = t >> 2, ak = (t & 3) * 4;
    const int bk = t >> 4, bc = (t & 15) * 4;
    for (int k0 = 0; k0 < K; k0 += 16) {
#pragma unroll
        for (int i = 0; i < 4; ++i) As[ak + i][ar] = ldf(A + (size_t)(bm + ar) * lda + k0 + ak + i);
#pragma unroll
        for (int i = 0; i < 4; ++i) { const int col = bn + bc + i; Bs[bk][bc + i] = col < N ? B[(size_t)(k0 + bk) * ldb + col] : 0.f; }
        __syncthreads();
#pragma unroll
        for (int k = 0; k < 16; ++k) {
            float a[4], b[4];
#pragma unroll
            for (int i = 0; i < 4; ++i) a[i] = As[k][ty * 4 + i];
#pragma unroll
            for (int j = 0; j < 4; ++j) b[j] = Bs[k][tx + 16 * j];
#pragma unroll
            for (int i = 0; i < 4; ++i)
#pragma unroll
                for (int j = 0; j < 4; ++j) acc[i][j] += a[i] * b[j];
        }
        __syncthreads();
    }
    epi(bm + ty * 4, bn + tx, acc, N);
}

struct EpiProj {
    Ctx c;
    __device__ void operator()(int row0, int colb, const float (&acc)[4][4], int N) const {
        const float* bias = c.in[11];
        bf16_t* QA = (bf16_t*)(c.ws + WS_QA); bf16_t* QC = (bf16_t*)(c.ws + WS_QC); bf16_t* CQ = (bf16_t*)(c.ws + WS_CQ);
        bf16_t* KA = (bf16_t*)(c.ws + WS_KA); bf16_t* VA = (bf16_t*)(c.ws + WS_VA); bf16_t* HALO = (bf16_t*)(c.ws + WS_HALO);
        float* ABBB = (float*)(c.ws + WS_ABBB); bf16_t* ZB = (bf16_t*)c.out + (size_t)NT * DM;
#pragma unroll
        for (int i = 0; i < 4; ++i) {
            const int row = row0 + i;
            const int pos = row < NP ? row : 2048 + ((row - NP) & 63);
            float v[4];
#pragma unroll
            for (int j = 0; j < 4; ++j) { const int col = colb + 16 * j; v[j] = col < N ? acc[i][j] + bias[col] : 0.f; }
            if (colb < C_VA) {
#pragma unroll
                for (int j = 0; j < 2; ++j) {
                    const int d = (colb + 16 * j) & 63;
                    const double ar = (double)pos * c.rt.inv_rev[d]; const float fr = (float)(ar - floor(ar));
                    const float cs = __builtin_amdgcn_cosf(fr), sn = __builtin_amdgcn_sinf(fr);
                    const float x1 = v[j], x2 = v[j + 2];
                    v[j] = x1 * cs - x2 * sn; v[j + 2] = x2 * cs + x1 * sn;
                }
            }
#pragma unroll
            for (int j = 0; j < 4; ++j) {
                const int col = colb + 16 * j; if (col >= N) continue;
                const float val = v[j];
                if (col < C_KA) QA[(size_t)row * DM + col] = f2bf(val);
                else if (col < C_QB) {
                    const int cc = col - C_KA;
                    const bool isk = cc < 128; const int c2 = cc & 127;
                    (isk ? KA : VA)[(size_t)row * 128 + c2] = f2bf(val);
                    if (row >= NP - 128 && row < NP) c.out[(isk ? O_PK : O_PV) + (size_t)(row - (NP - 128)) * 128 + c2] = val;
                    if (row >= NP) { const int b = (row - NP) >> 6, tt = (row - NP) & 63; c.out[(isk ? O_SK : O_SV) + ((size_t)b * 128 + 64 + tt) * 128 + c2] = val; }
                } else if (col < C_ZB) {
                    const int cc = col - C_QB;
                    const int which = cc >> 10, c2 = cc & 1023;
                    const bf16_t bv = f2bf(val);
                    CQ[(size_t)which * NT * DM + (size_t)row * DM + c2] = bv;
                    const int r64 = row & 63;
                    if (r64 >= 61) {
                        HALO[((size_t)(row >> 6) * 3 + (r64 - 61)) * 3072 + cc] = bv;
                        if (row >= NP - 3 && row < NP) c.out[O_PC + (size_t)(row - (NP - 3)) * 3072 + cc] = val;
                        if (row >= NP) { const int b = (row - NP) >> 6; c.out[O_SC + ((size_t)b * 3 + (r64 - 61)) * 3072 + cc] = val; }
                    }
                } else if (col < C_AB) ZB[(size_t)row * DM + (col - C_ZB)] = f2bf(val);
                else if (col < C_QC) ABBB[(size_t)row * 16 + (col - C_AB)] = val;
                else QC[(size_t)row * DM + (col - C_QC)] = f2bf(val);
            }
        }
    }
};
struct EpiMemKV {
    Ctx c;
    __device__ void operator()(int row0, int colb, const float (&acc)[4][4], int N) const {
        bf16_t* MK = (bf16_t*)(c.ws + WS_MK); bf16_t* MV = (bf16_t*)(c.ws + WS_MV);
#pragma unroll
        for (int i = 0; i < 4; ++i)
#pragma unroll
            for (int j = 0; j < 4; ++j) {
                const int row = row0 + i, col = colb + 16 * j; const float v = acc[i][j];
                if (col < 1024) { MK[(size_t)row * 1024 + col] = f2bf(v); c.out[O_PMK + (size_t)row * 1024 + col] = v; }
                else { MV[(size_t)row * 1024 + col - 1024] = f2bf(v); c.out[O_PMV + (size_t)row * 1024 + col - 1024] = v; }
            }
    }
};
struct EpiGates {
    bf16_t* G; const float* bias;
    __device__ void operator()(int row0, int colb, const float (&acc)[4][4], int N) const {
#pragma unroll
        for (int i = 0; i < 4; ++i)
#pragma unroll
            for (int j = 0; j < 4; ++j) { const int col = colb + 16 * j; G[(size_t)(row0 + i) * 3072 + col] = f2bf(sigmoidf_(acc[i][j] + bias[col])); }
    }
};
struct EpiBranch {
    float* MG; const bf16_t* G; int n;
    __device__ void operator()(int row0, int colb, const float (&acc)[4][4], int N) const {
#pragma unroll
        for (int i = 0; i < 4; ++i)
#pragma unroll
            for (int j = 0; j < 4; ++j) { const int row = row0 + i, col = colb + 16 * j; const size_t o = (size_t)row * DM + col;
                const float t = bf2f(G[(size_t)row * 3072 + n * 1024 + col]) * acc[i][j]; MG[o] = (n == 0 ? 0.f : MG[o]) + t; }
    }
};
struct EpiF32 {
    float* O; int ldc;
    __device__ void operator()(int row0, int colb, const float (&acc)[4][4], int N) const {
#pragma unroll
        for (int i = 0; i < 4; ++i)
#pragma unroll
            for (int j = 0; j < 4; ++j) O[(size_t)(row0 + i) * ldc + colb + 16 * j] = acc[i][j];
    }
};
struct EpiUp {
    bf16_t* O;
    __device__ void operator()(int row0, int colb, const float (&acc)[4][4], int N) const {
#pragma unroll
        for (int i = 0; i < 4; ++i)
#pragma unroll
            for (int j = 0; j < 4; ++j) { const float r = fmaxf(acc[i][j], 0.f); O[(size_t)(row0 + i) * DFF + colb + 16 * j] = f2bf(r * r); }
    }
};

__global__ void k_copy_cache(Ctx c) {
    const int i = blockIdx.x * 256 + threadIdx.x;
    if (i >= 16 * 64 * 128) return;
    const int b = i / (64 * 128), r = (i / 128) & 63, cc = i & 127;
    c.out[O_SK + ((size_t)b * 128 + r) * 128 + cc] = c.in[3][((size_t)b * 128 + 64 + r) * 128 + cc];
    c.out[O_SV + ((size_t)b * 128 + r) * 128 + cc] = c.in[4][((size_t)b * 128 + 64 + r) * 128 + cc];
}

__global__ void __launch_bounds__(256) k_swa(Ctx c) {
    const int gid = blockIdx.x * 256 + threadIdx.x;
    const int tl = gid & 63, h = (gid >> 6) & 15, ch = gid >> 10;
    if (ch >= NCH) return;
    const int tok = ch * 64 + tl, kvh = h >> 3;
    bf16_t* QA = (bf16_t*)(c.ws + WS_QA); const bf16_t* KA = (const bf16_t*)(c.ws + WS_KA); const bf16_t* VA = (const bf16_t*)(c.ws + WS_VA);
    float q[64], o[64];
#pragma unroll
    for (int d = 0; d < 64; ++d) { q[d] = bf2f(QA[(size_t)tok * DM + h * 64 + d]) * 0.125f; o[d] = 0.f; }
    float m = c.in[12][h], l = 1.f;
    const bool samp = ch >= 256; const int b = ch - 256;
    for (int j = 0; j < 192; ++j) {
        float s = 0.f; float p, sc;
        if (j < 128 && samp) {
            const float* kp = c.in[3] + (((size_t)b * 128 + j) * 2 + kvh) * 64; const float* vp = c.in[4] + (((size_t)b * 128 + j) * 2 + kvh) * 64;
#pragma unroll
            for (int d = 0; d < 64; ++d) s += q[d] * kp[d];
            const float mn = fmaxf(m, s); sc = expf(m - mn); p = expf(s - mn); l = l * sc + p; m = mn;
#pragma unroll
            for (int d = 0; d < 64; ++d) o[d] = o[d] * sc + p * vp[d];
        } else {
            const int pk = ch * 64 - 128 + j; if (pk < 0) continue;
            const bf16_t* kp = KA + (size_t)pk * 128 + kvh * 64; const bf16_t* vp = VA + (size_t)pk * 128 + kvh * 64;
#pragma unroll
            for (int d = 0; d < 64; ++d) s += q[d] * bf2f(kp[d]);
            const float mn = fmaxf(m, s); sc = expf(m - mn); p = expf(s - mn); l = l * sc + p; m = mn;
#pragma unroll
            for (int d = 0; d < 64; ++d) o[d] = o[d] * sc + p * bf2f(vp[d]);
        }
    }
    const float il = 1.f / l;
#pragma unroll
    for (int d = 0; d < 64; ++d) QA[(size_t)tok * DM + h * 64 + d] = f2bf(o[d] * il);
}

__global__ void __launch_bounds__(256) k_memattn(Ctx c) {
    __shared__ float qs[16][256];
    __shared__ float ps[16][256];
    const int t = threadIdx.x, h = blockIdx.x & 3, tile = blockIdx.x >> 2, tok0 = tile * 16;
    bf16_t* QC = (bf16_t*)(c.ws + WS_QC);
    const bool samp = tok0 >= NP; const int b = (tok0 - NP) >> 6;
    for (int i = 0; i < 16; ++i) qs[i][t] = bf2f(QC[(size_t)(tok0 + i) * DM + h * 256 + t]) * 0.0625f;
    __syncthreads();
    {
        float acc[16];
#pragma unroll
        for (int i = 0; i < 16; ++i) acc[i] = 0.f;
        const bf16_t* kb = (const bf16_t*)(c.ws + WS_MK) + (size_t)t * 1024 + h * 256;
        const float* kf = c.in[7] + ((size_t)b * 256 + t) * 1024 + h * 256;
        for (int d = 0; d < 256; ++d) {
            const float kv = samp ? kf[d] : bf2f(kb[d]);
#pragma unroll
            for (int i = 0; i < 16; ++i) acc[i] += qs[i][d] * kv;
        }
#pragma unroll
        for (int i = 0; i < 16; ++i) ps[i][t] = acc[i];
    }
    __syncthreads();
    {
        const int w = t >> 6, lane = t & 63;
        for (int r = 0; r < 4; ++r) {
            const int i = w * 4 + r;
            float v0 = ps[i][lane], v1 = ps[i][lane + 64], v2 = ps[i][lane + 128], v3 = ps[i][lane + 192];
            const float m = wave_max(fmaxf(fmaxf(v0, v1), fmaxf(v2, v3)));
            v0 = expf(v0 - m); v1 = expf(v1 - m); v2 = expf(v2 - m); v3 = expf(v3 - m);
            const float inv = 1.f / wave_sum(v0 + v1 + v2 + v3);
            ps[i][lane] = v0 * inv; ps[i][lane + 64] = v1 * inv; ps[i][lane + 128] = v2 * inv; ps[i][lane + 192] = v3 * inv;
        }
    }
    __syncthreads();
    {
        float acc[16];
#pragma unroll
        for (int i = 0; i < 16; ++i) acc[i] = 0.f;
        const bf16_t* vb = (const bf16_t*)(c.ws + WS_MV) + h * 256 + t;
        const float* vf = c.in[8] + (size_t)b * 256 * 1024 + h * 256 + t;
        for (int j = 0; j < 256; ++j) {
            const float vv = samp ? vf[(size_t)j * 1024] : bf2f(vb[(size_t)j * 1024]);
#pragma unroll
            for (int i = 0; i < 16; ++i) acc[i] += ps[i][j] * vv;
        }
#pragma unroll
        for (int i = 0; i < 16; ++i) QC[(size_t)(tok0 + i) * DM + h * 256 + t] = f2bf(acc[i]);
    }
}

__global__ void __launch_bounds__(256) k_gdn_prep(Ctx c) {
    __shared__ float tile[67][129];
    __shared__ float rs[64];
    const int t = threadIdx.x, ch = blockIdx.x >> 3, h = blockIdx.x & 7;
    const bf16_t* HALO = (const bf16_t*)(c.ws + WS_HALO);
    const bool samp = ch >= 256; const int b = ch - 256;
    for (int which = 0; which < 3; ++which) {
        bf16_t* X = (bf16_t*)(c.ws + WS_CQ) + (size_t)which * NT * DM;
        const int chbase = which * 1024 + h * 128;
        for (int e = t; e < 67 * 128; e += 256) {
            const int r = e >> 7, cc = e & 127; float v;
            if (r < 3) {
                if (samp) v = c.in[6][((size_t)b * 3 + r) * 3072 + chbase + cc];
                else if (ch == 0) v = 0.f;
                else v = bf2f(HALO[((size_t)(ch - 1) * 3 + r) * 3072 + chbase + cc]);
            } else v = bf2f(X[(size_t)(ch * 64 + r - 3) * DM + h * 128 + cc]);
            tile[r][cc] = v;
        }
        __syncthreads();
        const float* cw = c.in[13];
        float yv[32];
        {
            const int cc = t & 127, r0 = (t >> 7) * 32;
            const float w0 = cw[chbase + cc], w1 = cw[3072 + chbase + cc], w2 = cw[2 * 3072 + chbase + cc], w3 = cw[3 * 3072 + chbase + cc];
#pragma unroll
            for (int i = 0; i < 32; ++i) {
                const int r = r0 + i;
                const float y = w0 * tile[r][cc] + w1 * tile[r + 1][cc] + w2 * tile[r + 2][cc] + w3 * tile[r + 3][cc];
                yv[i] = y * sigmoidf_(y);
            }
        }
        __syncthreads();
        {
            const int cc = t & 127, r0 = (t >> 7) * 32;
#pragma unroll
            for (int i = 0; i < 32; ++i) tile[r0 + i][cc] = yv[i];
        }
        __syncthreads();
        if (which < 2) {
            const int w = t >> 6, lane = t & 63;
            for (int r = w; r < 64; r += 4) {
                const float a = tile[r][lane], bb = tile[r][lane + 64];
                const float ss = wave_sum(a * a + bb * bb);
                if (lane == 0) rs[r] = (1.f / sqrtf(ss + 1e-6f)) * (which == 0 ? 0.08838834764831845f : 1.f);
            }
        } else if (t < 64) rs[t] = 1.f;
        __syncthreads();
        for (int e = t; e < 64 * 128; e += 256) { const int r = e >> 7, cc = e & 127; X[(size_t)(ch * 64 + r) * DM + h * 128 + cc] = f2bf(tile[r][cc] * rs[r]); }
        __syncthreads();
    }
    if (t < 64) {
        const int tok = ch * 64 + t; const float* ab = (const float*)(c.ws + WS_ABBB) + (size_t)tok * 16;
        const float a = ab[h] + c.in[15][h], bb = ab[8 + h];
        const float sp = a > 20.f ? a : log1pf(expf(a));
        ((float*)(c.ws + WS_LA))[(size_t)tok * 8 + h] = -expf(c.in[14][h]) * sp;
        ((float*)(c.ws + WS_BETA))[(size_t)tok * 8 + h] = sigmoidf_(bb);
    }
}

__global__ void __launch_bounds__(128) k_gdn_scan(Ctx c) {
    __shared__ float ks[128], qs[128], red[2];
    const int t = threadIdx.x, seq = blockIdx.x >> 3, h = blockIdx.x & 7;
    const int tok0 = seq == 0 ? 0 : NP + (seq - 1) * 64, ntok = seq == 0 ? NP : 64;
    const bf16_t* QN = (const bf16_t*)(c.ws + WS_CQ); const bf16_t* KN = (const bf16_t*)(c.ws + WS_CK); const bf16_t* VV = (const bf16_t*)(c.ws + WS_CV);
    const float* LA = (const float*)(c.ws + WS_LA); const float* BETA = (const float*)(c.ws + WS_BETA);
    bf16_t* ZB = (bf16_t*)c.out + (size_t)NT * DM;
    float S[128];
    if (seq == 0) {
#pragma unroll
        for (int i = 0; i < 128; ++i) S[i] = 0.f;
    } else {
        const float* s0 = c.in[5] + ((size_t)(seq - 1) * 8 + h) * 16384;
#pragma unroll
        for (int i = 0; i < 128; ++i) S[i] = s0[i * 128 + t];
    }
    const float ng = c.in[16][t];
    for (int n = 0; n < ntok; ++n) {
        const int tok = tok0 + n; const size_t off = (size_t)tok * DM + h * 128 + t;
        ks[t] = bf2f(KN[off]); qs[t] = bf2f(QN[off]);
        const float v = bf2f(VV[off]), a = expf(LA[(size_t)tok * 8 + h]), be = BETA[(size_t)tok * 8 + h];
        __syncthreads();
        float kS = 0.f;
#pragma unroll
        for (int i = 0; i < 128; ++i) kS += ks[i] * S[i];
        const float d = be * (v - a * kS);
        float o = 0.f;
#pragma unroll
        for (int i = 0; i < 128; ++i) { S[i] = a * S[i] + ks[i] * d; o += qs[i] * S[i]; }
        const float ss = wave_sum(o * o);
        if ((t & 63) == 0) red[t >> 6] = ss;
        __syncthreads();
        const float rstd = 1.f / sqrtf((red[0] + red[1]) * (1.f / 128.f) + 1e-6f);
        const float z = bf2f(ZB[off]);
        ZB[off] = f2bf(o * rstd * ng * (z * sigmoidf_(z)));
    }
    float* so = seq == 0 ? c.out + O_PG + (size_t)h * 16384 : c.out + O_SG + ((size_t)(seq - 1) * 8 + h) * 16384;
#pragma unroll
    for (int i = 0; i < 128; ++i) so[i * 128 + t] = S[i];
}

__global__ void __launch_bounds__(256) k_resnorm1(Ctx c, const float* Y1, bf16_t* HF) {
    const int lane = threadIdx.x & 63, row = blockIdx.x * 4 + (threadIdx.x >> 6);
    if (row >= NT) return;
    const float* x = xrow(c, row); const float* y = Y1 + (size_t)row * DM;
    float v[16], xv[16]; float s = 0.f;
#pragma unroll
    for (int j = 0; j < 16; ++j) { v[j] = y[lane + 64 * j]; s += v[j] * v[j]; }
    const float r1 = 1.f / sqrtf(wave_sum(s) * (1.f / DM) + 1e-6f);
    float s2 = 0.f;
#pragma unroll
    for (int j = 0; j < 16; ++j) { xv[j] = x[lane + 64 * j] + v[j] * r1 * c.in[21][lane + 64 * j]; s2 += xv[j] * xv[j]; }
    const float r2 = 1.f / sqrtf(wave_sum(s2) * (1.f / DM) + 1e-6f);
#pragma unroll
    for (int j = 0; j < 16; ++j) { c.out[(size_t)row * DM + lane + 64 * j] = xv[j]; HF[(size_t)row * DM + lane + 64 * j] = f2bf(xv[j] * r2 * c.in[22][lane + 64 * j]); }
}
__global__ void __launch_bounds__(256) k_resnorm2(Ctx c, const float* F) {
    const int lane = threadIdx.x & 63, row = blockIdx.x * 4 + (threadIdx.x >> 6);
    if (row >= NT) return;
    const float* y = F + (size_t)row * DM;
    float v[16]; float s = 0.f;
#pragma unroll
    for (int j = 0; j < 16; ++j) { v[j] = y[lane + 64 * j]; s += v[j] * v[j]; }
    const float r1 = 1.f / sqrtf(wave_sum(s) * (1.f / DM) + 1e-6f);
#pragma unroll
    for (int j = 0; j < 16; ++j) { const size_t o = (size_t)row * DM + lane + 64 * j; c.out[o] = c.out[o] + v[j] * r1 * c.in[25][lane + 64 * j]; }
}

extern "C" void kernel_launch(void* const* d_in, const int* in_sizes, int n_in, void* d_out, int out_size, void* d_ws, size_t ws_size, hipStream_t stream) {
    Ctx c{};
    for (int i = 0; i < 26; ++i) c.in[i] = (const float*)d_in[i];
    c.out = (float*)d_out; c.ws = (unsigned char*)d_ws;
    for (int d = 0; d < 32; ++d) c.rt.inv_rev[d] = pow(10000.0, -(double)d / 32.0) / (2.0 * M_PI);
    unsigned char* ws = c.ws;
    bf16_t* H = (bf16_t*)d_out;
    k_rms_h<<<NT / 4, 256, 0, stream>>>(c);
    k_rms_mem<<<64, 256, 0, stream>>>(c);
    k_copy_cache<<<(16 * 64 * 128) / 256, 256, 0, stream>>>(c);
    k_gemm<bf16_t, EpiProj><<<dim3((C_GL + 63) / 64, NT / 64), 256, 0, stream>>>(H, DM, c.in[10], DIN, NT, C_GL, DM, EpiProj{c});
    k_gemm<float, EpiMemKV><<<dim3(2048 / 64, 256 / 64), 256, 0, stream>>>((const float*)(ws + WS_MEMN), DM, c.in[18], 2048, 256, 2048, DM, EpiMemKV{c});
    k_swa<<<(NCH * 1024) / 256, 256, 0, stream>>>(c);
    k_memattn<<<(NT / 16) * 4, 256, 0, stream>>>(c);
    k_gdn_prep<<<NCH * 8, 256, 0, stream>>>(c);
    k_gdn_scan<<<17 * 8, 128, 0, stream>>>(c);
    bf16_t* G = (bf16_t*)(ws + WS_CQ); float* MG = (float*)(ws + 188 * MiB);
    k_gemm<bf16_t, EpiGates><<<dim3(3072 / 64, NT / 64), 256, 0, stream>>>(H, DM, c.in[10] + C_GL, DIN, NT, 3072, DM, EpiGates{G, c.in[11] + C_GL});
    const bf16_t* OA = (const bf16_t*)(ws + WS_QA); const bf16_t* OB = (const bf16_t*)d_out + (size_t)NT * DM; const bf16_t* OC = (const bf16_t*)(ws + WS_QC);
    k_gemm<bf16_t, EpiBranch><<<dim3(16, NT / 64), 256, 0, stream>>>(OA, DM, c.in[19], DM, NT, DM, DM, EpiBranch{MG, G, 0});
    k_gemm<bf16_t, EpiBranch><<<dim3(16, NT / 64), 256, 0, stream>>>(OB, DM, c.in[19] + (size_t)DM * DM, DM, NT, DM, DM, EpiBranch{MG, G, 1});
    k_gemm<bf16_t, EpiBranch><<<dim3(16, NT / 64), 256, 0, stream>>>(OC, DM, c.in[19] + (size_t)2 * DM * DM, DM, NT, DM, DM, EpiBranch{MG, G, 2});
    float* Y1 = (float*)(ws + 0); bf16_t* HF = (bf16_t*)(ws + 68 * MiB); bf16_t* HID = (bf16_t*)(ws + 102 * MiB); float* FF = (float*)(ws + 0);
    k_gemm<float, EpiF32><<<dim3(16, NT / 64), 256, 0, stream>>>(MG, DM, c.in[20], DM, NT, DM, DM, EpiF32{Y1, DM});
    k_resnorm1<<<NT / 4, 256, 0, stream>>>(c, Y1, HF);
    k_gemm<bf16_t, EpiUp><<<dim3(DFF / 64, NT / 64), 256, 0, stream>>>(HF, DM, c.in[23], DFF, NT, DFF, DM, EpiUp{HID});
    k_gemm<bf16_t, EpiF32><<<dim3(16, NT / 64), 256, 0, stream>>>(HID, DFF, c.in[24], DM, NT, DM, DFF, EpiF32{FF, DM});
    k_resnorm2<<<NT / 4, 256, 0, stream>>>(c, FF);
}
```
